# Optimizing an MI355X kernel written in HIP

```python
import jax, jax.numpy as jnp
from jax import lax
import numpy as np

D_MODEL = 1024
BATCH = 4
SEQ = 4096
DEPTH = 1

HEAD_DIM = 64
A_Q_HEADS = 8
A_KV_HEADS = 2
B_GROUPS = ((128, 1), (512, 4), (2048, 16))
B_HEADS_PER_GROUP = 4
B_HEADS = B_HEADS_PER_GROUP * len(B_GROUPS)
A_Q_W = A_Q_HEADS * HEAD_DIM
A_KV_W = A_KV_HEADS * HEAD_DIM
B_W = B_HEADS * HEAD_DIM
B_OUT_W = B_HEADS_PER_GROUP * HEAD_DIM
QKV_COLS = A_Q_W + 2 * A_KV_W + 3 * B_W
QKV_SPLITS = [A_Q_W, A_Q_W + A_KV_W, A_Q_W + 2 * A_KV_W,
              A_Q_W + 2 * A_KV_W + B_W, A_Q_W + 2 * A_KV_W + 2 * B_W]
D_FF = -(-(8 * D_MODEL) // (3 * 256)) * 256
GRID_W = 64
Q_BLOCK = 128
AXIAL_THETA = 10000.0
PARTIAL_THETA = 500000.0
PARTIAL_ROT_DIM = HEAD_DIM // 4
EPS = 1e-6
NEG_INF = -1e30

kernel_name = "hybrid_gqa_axial_dilated_swa_adaln_block"


def _rms(x, g):
    xf = x.astype(jnp.float32)
    y = xf * lax.rsqrt(jnp.mean(xf * xf, axis=-1, keepdims=True) + EPS)
    return (y * g.astype(jnp.float32)).astype(x.dtype)


def _rope_angles(pos, dim, theta):
    inv = theta ** (-jnp.arange(0, dim, 2, dtype=jnp.float32) / dim)
    ang = pos.astype(jnp.float32)[:, None] * inv[None, :]
    return jnp.cos(ang), jnp.sin(ang)


def _rotate(x, cos, sin):
    half = x.shape[-1] // 2
    x1 = x[..., :half].astype(jnp.float32)
    x2 = x[..., half:].astype(jnp.float32)
    c = cos[None, :, None, :]
    s = sin[None, :, None, :]
    return jnp.concatenate([x1 * c - x2 * s, x2 * c + x1 * s], axis=-1).astype(x.dtype)


def _axial_rope(x, row, col):
    half = HEAD_DIM // 2
    cr, sr = _rope_angles(row, half, AXIAL_THETA)
    cc, sc = _rope_angles(col, half, AXIAL_THETA)
    return jnp.concatenate([_rotate(x[..., :half], cr, sr),
                            _rotate(x[..., half:], cc, sc)], axis=-1)


def _partial_rope(x, pos):
    cr, sr = _rope_angles(pos, PARTIAL_ROT_DIM, PARTIAL_THETA)
    return jnp.concatenate([_rotate(x[..., :PARTIAL_ROT_DIM], cr, sr),
                            x[..., PARTIAL_ROT_DIM:]], axis=-1)


def _global_gqa(q, k, v):
    b, s, _, d = q.shape
    g = A_Q_HEADS // A_KV_HEADS
    nq = s // Q_BLOCK
    qb = q.reshape(b, nq, Q_BLOCK, A_KV_HEADS, g, d).transpose(1, 0, 2, 3, 4, 5)
    scale = d ** -0.5

    def attend(qblk):
        sc = jnp.einsum('bqhgd,bkhd->bhgqk', qblk, k).astype(jnp.float32) * scale
        p = jax.nn.softmax(sc, axis=-1)
        return jnp.einsum('bhgqk,bkhd->bqhgd', p.astype(v.dtype), v)

    o = lax.map(attend, qb)
    return o.transpose(1, 0, 2, 3, 4, 5).reshape(b, s, A_Q_HEADS * d)


def _banded(q, k, v, radius):
    L, d = q.shape[-2], q.shape[-1]
    blk = radius
    nb = -(-L // blk)
    lp = nb * blk
    lead = q.shape[:-2]
    pad = [(0, 0)] * len(lead)
    qp = jnp.pad(q, pad + [(0, lp - L), (0, 0)]).reshape(*lead, nb, blk, d)

    def windows(t):
        tp = jnp.pad(t, pad + [(blk, lp - L + blk), (0, 0)]).reshape(*lead, nb + 2, blk, d)
        return jnp.concatenate([tp[..., :-2, :, :], tp[..., 1:-1, :, :], tp[..., 2:, :, :]], axis=-2)

    kw, vw = windows(k), windows(v)
    s = jnp.einsum('...nqd,...nkd->...nqk', qp, kw).astype(jnp.float32) * (d ** -0.5)
    qpos = jnp.arange(nb)[:, None] * blk + jnp.arange(blk)[None, :]
    kpos = (jnp.arange(nb)[:, None] - 1) * blk + jnp.arange(3 * blk)[None, :]
    kp = kpos[:, None, :]
    valid = (jnp.abs(qpos[:, :, None] - kp) <= radius) & (kp >= 0) & (kp < L)
    s = jnp.where(valid, s, NEG_INF)
    lse = jax.nn.logsumexp(s, axis=-1, keepdims=True)
    p = jnp.exp(s - lse)
    o = jnp.einsum('...nqk,...nkd->...nqd', p.astype(v.dtype), vw)
    o = o.reshape(*lead, lp, d)[..., :L, :]
    return o, lse.reshape(*lead, lp)[..., :L]


def _dilated_swa(q, k, v):
    b, s, _, d = q.shape
    h = B_HEADS_PER_GROUP
    outs, lses = [], []
    for gi, (window, dil) in enumerate(B_GROUPS):
        lo, hi = gi * h, (gi + 1) * h
        L = s // dil
        qs = q[:, :, lo:hi].reshape(b, L, dil, h, d).transpose(0, 2, 3, 1, 4)
        ks = k[:, :, lo:hi].reshape(b, L, dil, h, d).transpose(0, 2, 3, 1, 4)
        vs = v[:, :, lo:hi].reshape(b, L, dil, h, d).transpose(0, 2, 3, 1, 4)
        o, lse = _banded(qs, ks, vs, window // 2 // dil)
        outs.append(o.transpose(0, 3, 1, 2, 4).reshape(b, s, h, d))
        lses.append(lse.transpose(0, 3, 1, 2).reshape(b, s, h))
    o_all = jnp.stack(outs, axis=0)
    lse_all = jnp.stack(lses, axis=0)
    w = jax.nn.softmax(lse_all, axis=0)
    out = jnp.sum(w[..., None].astype(o_all.dtype) * o_all, axis=0)
    return out.reshape(b, s, h * d)


def setup_inputs(seed: int = 0) -> dict:
    key = jax.random.key(seed)
    ks = jax.random.split(key, 17)

    def nrm(k, shape, fan_in, s=1.0):
        return jax.random.normal(k, shape, jnp.float32) * (s * fan_in ** -0.5)

    def gain(k, shape):
        return 1.0 + 0.1 * jax.random.normal(k, shape, jnp.float32)

    return {
        "x": jax.random.normal(ks[0], (BATCH, SEQ, D_MODEL), jnp.float32),
        "c": jax.random.normal(ks[1], (BATCH, D_MODEL), jnp.float32),
        "w_ada": nrm(ks[2], (DEPTH, D_MODEL, 6 * D_MODEL), D_MODEL, 0.5),
        "b_ada": 0.02 * jax.random.normal(ks[3], (DEPTH, 6 * D_MODEL), jnp.float32),
        "norm1_g": gain(ks[4], (DEPTH, D_MODEL)),
        "w_qkv": nrm(ks[5], (DEPTH, D_MODEL, QKV_COLS), D_MODEL),
        "q_norm_a": gain(ks[6], (DEPTH, HEAD_DIM)),
        "k_norm_a": gain(ks[7], (DEPTH, HEAD_DIM)),
        "w_proj_a": nrm(ks[8], (DEPTH, A_Q_W, D_MODEL), A_Q_W),
        "w_proj_b": nrm(ks[9], (DEPTH, B_OUT_W, D_MODEL), B_OUT_W),
        "w_gate": nrm(ks[10], (DEPTH, D_MODEL, 2 * D_MODEL), D_MODEL),
        "b_gate": 0.1 * jax.random.normal(ks[11], (DEPTH, 2 * D_MODEL), jnp.float32),
        "w_o": nrm(ks[12], (DEPTH, D_MODEL, D_MODEL), D_MODEL),
        "norm2_g": gain(ks[13], (DEPTH, D_MODEL)),
        "w_ffn_in": nrm(ks[14], (DEPTH, D_MODEL, 2 * D_FF), D_MODEL),
        "w_ffn_out": nrm(ks[15], (DEPTH, D_FF, D_MODEL), D_FF),
        "final_norm_g": gain(ks[16], (D_MODEL,)),
    }


def reference(x, c, w_ada, b_ada, norm1_g, w_qkv, q_norm_a, k_norm_a, w_proj_a, w_proj_b,
              w_gate, b_gate, w_o, norm2_g, w_ffn_in, w_ffn_out, final_norm_g):
    b, s, _ = x.shape
    rows = s // GRID_W
    row = jnp.repeat(jnp.arange(rows, dtype=jnp.int32), GRID_W)
    col = jnp.tile(jnp.arange(GRID_W, dtype=jnp.int32), rows)
    pos = jnp.arange(s, dtype=jnp.int32)
    cond = jax.nn.silu(c)
    for l in range(DEPTH):
        mod = cond @ w_ada[l] + b_ada[l]
        sh1, sc1, g1, sh2, sc2, g2 = jnp.split(mod, 6, axis=-1)
        u = _rms(x, norm1_g[l]) * (1.0 + sc1[:, None, :]) + sh1[:, None, :]
        qkv = u @ w_qkv[l]
        qa, ka, va, qb, kb, vb = jnp.split(qkv, QKV_SPLITS, axis=-1)
        qa = qa.reshape(b, s, A_Q_HEADS, HEAD_DIM)
        ka = ka.reshape(b, s, A_KV_HEADS, HEAD_DIM)
        va = va.reshape(b, s, A_KV_HEADS, HEAD_DIM)
        qa = _axial_rope(_rms(qa, q_norm_a[l]), row, col)
        ka = _axial_rope(_rms(ka, k_norm_a[l]), row, col)
        ya = _global_gqa(qa, ka, va) @ w_proj_a[l]
        qb = _partial_rope(qb.reshape(b, s, B_HEADS, HEAD_DIM), pos)
        kb = _partial_rope(kb.reshape(b, s, B_HEADS, HEAD_DIM), pos)
        vb = vb.reshape(b, s, B_HEADS, HEAD_DIM)
        yb = _dilated_swa(qb, kb, vb) @ w_proj_b[l]
        gates = jax.nn.sigmoid(u @ w_gate[l] + b_gate[l])
        ga, gb = jnp.split(gates, 2, axis=-1)
        mix = (ga * ya + gb * yb) @ w_o[l]
        x = x + g1[:, None, :] * mix
        u2 = _rms(x, norm2_g[l]) * (1.0 + sc2[:, None, :]) + sh2[:, None, :]
        hg, hu = jnp.split(u2 @ w_ffn_in[l], 2, axis=-1)
        x = x + g2[:, None, :] * ((jax.nn.silu(hg) * hu) @ w_ffn_out[l])
    return _rms(x, final_norm_g)
```

```cpp
#include <hip/hip_runtime.h>
#include <cstdint>
#include <cstdio>

typedef unsigned short bf16_t;
typedef float f32x4 __attribute__((ext_vector_type(4)));

constexpr int BATCH = 4, SEQ = 4096, DM = 1024, M = BATCH * SEQ;
constexpr int HD = 64, AQH = 8, AKVH = 2, BH = 12;
constexpr int QKV_COLS = 3072, DFF = 2816;
constexpr float EPS = 1e-6f;
constexpr float C2 = 0.125f * 1.4426950408889634f;
constexpr float LN2 = 0.6931471805599453f;

__device__ __forceinline__ float bf2f(bf16_t v) { return __uint_as_float((unsigned)v << 16); }
__device__ __forceinline__ bf16_t f2bf(float f) { unsigned u = __float_as_uint(f); return (bf16_t)((u + 0x7fffu + ((u >> 16) & 1u)) >> 16); }

constexpr size_t MiB = 1u << 20;
constexpr size_t WS_CTL = 0;
constexpr size_t WS_MOD = 1 * MiB;
constexpr size_t WS_LSE = 2 * MiB;
constexpr size_t WS_COMB = 3 * MiB;
constexpr size_t WS_W = 11 * MiB;
constexpr size_t WS_U = 43 * MiB;
constexpr size_t WS_QA = 75 * MiB;
constexpr size_t WS_KA = 91 * MiB;
constexpr size_t WS_VA = 95 * MiB;
constexpr size_t WS_QB = 99 * MiB;
constexpr size_t WS_KB = 123 * MiB;
constexpr size_t WS_VB = 147 * MiB;
constexpr size_t WS_G = 171 * MiB;
constexpr size_t WS_MIXIN = WS_KB;
constexpr size_t WS_ACT = WS_QA;
constexpr size_t WS_END = 235 * MiB;

__device__ __forceinline__ float wave_sum(float v) {
#pragma unroll
    for (int o = 1; o < 64; o <<= 1) v += __shfl_xor(v, o);
    return v;
}

template <typename AT>
__device__ __forceinline__ void dot64(const AT* arow, int K, const float* __restrict__ W, int ldw, int col0, float (&acc)[64]) {
#pragma unroll
    for (int h = 0; h < 4; ++h) {
        for (int k = 0; k < K; ++k) {
            float a;
            if constexpr (sizeof(AT) == 2) a = bf2f(arow[k]); else a = arow[k];
            const float* w = W + (size_t)k * ldw + col0 + h * 16;
#pragma unroll
            for (int j = 0; j < 16; ++j) acc[h * 16 + j] = __builtin_fmaf(a, w[j], acc[h * 16 + j]);
        }
    }
}

__device__ __forceinline__ constexpr float ax_inv(int d) {
    switch (d) {
        case 0: return 1.0f;
        case 1: return 0.5623413251903491f;
        case 2: return 0.31622776601683794f;
        case 3: return 0.1778279410038923f;
        case 4: return 0.1f;
        case 5: return 0.05623413251903491f;
        case 6: return 0.03162277660168379f;
        case 7: return 0.01778279410038923f;
        case 8: return 0.01f;
        case 9: return 0.005623413251903491f;
        case 10: return 0.0031622776601683794f;
        case 11: return 0.0017782794100389228f;
        case 12: return 0.001f;
        case 13: return 0.0005623413251903491f;
        case 14: return 0.00031622776601683794f;
        case 15: return 0.00017782794100389227f;
        default: return 0.f;
    }
}
__device__ __forceinline__ constexpr float pr_inv(int d) {
    switch (d) {
        case 0: return 1.0f;
        case 1: return 0.19392274474868576f;
        case 2: return 0.03760603093086393f;
        case 3: return 0.007292664737217109f;
        case 4: return 0.001414213562373095f;
        case 5: return 0.0002742481756762073f;
        case 6: return 5.318295896944988e-05f;
        case 7: return 1.031338537721246e-05f;
        default: return 0.f;
    }
}
__device__ __forceinline__ void sincos_acc(float ang, float& s, float& c) {
    const double rev = (double)ang * 0.15915494309189535;
    const float f = (float)(rev - __builtin_rint(rev));
    s = __builtin_amdgcn_sinf(f); c = __builtin_amdgcn_cosf(f);
}

__global__ void __launch_bounds__(256) k_mod(const float* c, const float* w_ada, const float* b_ada, float* mod) {
    const int n = blockIdx.x * 256 + threadIdx.x;
    float acc[4] = {0.f, 0.f, 0.f, 0.f};
    for (int k = 0; k < DM; ++k) {
        const float w = w_ada[(size_t)k * 6144 + n];
#pragma unroll
        for (int b = 0; b < 4; ++b) { const float cv = c[b * DM + k]; const float sv = cv / (1.f + __expf(-cv)); acc[b] = __builtin_fmaf(sv, w, acc[b]); }
    }
#pragma unroll
    for (int b = 0; b < 4; ++b) mod[b * 6144 + n] = acc[b] + b_ada[n];
}

__global__ void __launch_bounds__(256) k_rmsmod(const float* x, const float* g, const float* mod, int sh_off, int sc_off, bf16_t* out) {
    const int lane = threadIdx.x & 63, row = blockIdx.x * 4 + (threadIdx.x >> 6);
    const int b = row / SEQ;
    const float* xr = x + (size_t)row * DM;
    f32x4 v[4]; float s = 0.f;
#pragma unroll
    for (int j = 0; j < 4; ++j) { v[j] = *(const f32x4*)(xr + 4 * lane + 256 * j); s += v[j].x * v[j].x + v[j].y * v[j].y + v[j].z * v[j].z + v[j].w * v[j].w; }
    const float rstd = 1.f / sqrtf(wave_sum(s) * (1.f / DM) + EPS);
#pragma unroll
    for (int j = 0; j < 4; ++j) {
        const int c0 = 4 * lane + 256 * j;
#pragma unroll
        for (int e = 0; e < 4; ++e) {
            const int col = c0 + e;
            const float y = v[j][e] * rstd * g[col] * (1.f + mod[b * 6144 + sc_off + col]) + mod[b * 6144 + sh_off + col];
            out[(size_t)row * DM + col] = f2bf(y);
        }
    }
}

__global__ void __launch_bounds__(256) k_rmsfinal(float* x, const float* g) {
    const int lane = threadIdx.x & 63, row = blockIdx.x * 4 + (threadIdx.x >> 6);
    float* xr = x + (size_t)row * DM;
    f32x4 v[4]; float s = 0.f;
#pragma unroll
    for (int j = 0; j < 4; ++j) { v[j] = *(const f32x4*)(xr + 4 * lane + 256 * j); s += v[j].x * v[j].x + v[j].y * v[j].y + v[j].z * v[j].z + v[j].w * v[j].w; }
    const float rstd = 1.f / sqrtf(wave_sum(s) * (1.f / DM) + EPS);
#pragma unroll
    for (int j = 0; j < 4; ++j) { const f32x4 gg = *(const f32x4*)(g + 4 * lane + 256 * j); *(f32x4*)(xr + 4 * lane + 256 * j) = v[j] * rstd * gg; }
}

__device__ __forceinline__ int sidx_of(int t, int g) { const int sh = 2 * g, dil = 1 << sh, L = SEQ >> sh; return (t & (dil - 1)) * L + (t >> sh); }

__global__ void __launch_bounds__(256) k_qkv(const bf16_t* U, const float* w_qkv, const float* w_gate, const float* b_gate, const float* qn, const float* kn,
                                             bf16_t* QA, bf16_t* KA, bf16_t* VA, bf16_t* QB, bf16_t* KB, bf16_t* VB, bf16_t* G) {
    const int m = blockIdx.x * 256 + threadIdx.x, chunk = blockIdx.y;
    const int b = m / SEQ, t = m % SEQ;
    float acc[64];
#pragma unroll
    for (int j = 0; j < 64; ++j) acc[j] = 0.f;
    const bf16_t* urow = U + (size_t)m * DM;
    if (chunk < 48) dot64(urow, DM, w_qkv, QKV_COLS, chunk * 64, acc);
    else dot64(urow, DM, w_gate, 2048, (chunk - 48) * 64, acc);
    if (chunk < 10) {
        const float* gn = chunk < 8 ? qn : kn;
        float ss = 0.f;
#pragma unroll
        for (int j = 0; j < 64; ++j) ss += acc[j] * acc[j];
        const float rstd = 1.f / sqrtf(ss * (1.f / 64.f) + EPS);
#pragma unroll
        for (int j = 0; j < 64; ++j) acc[j] = acc[j] * rstd * gn[j];
        const int row = t / 64, col = t % 64;
#pragma unroll
        for (int d = 0; d < 16; ++d) {
            const float inv = ax_inv(d);
            float s, c;
            sincos_acc((float)row * inv, s, c);
            { const float x1 = acc[d], x2 = acc[d + 16]; acc[d] = x1 * c - x2 * s; acc[d + 16] = x2 * c + x1 * s; }
            sincos_acc((float)col * inv, s, c);
            { const float x1 = acc[32 + d], x2 = acc[48 + d]; acc[32 + d] = x1 * c - x2 * s; acc[48 + d] = x2 * c + x1 * s; }
        }
        if (chunk < 8) {
#pragma unroll
            for (int j = 0; j < 64; ++j) QA[(size_t)m * 512 + chunk * 64 + j] = f2bf(acc[j] * C2);
        } else {
#pragma unroll
            for (int j = 0; j < 64; ++j) KA[(size_t)m * 128 + (chunk - 8) * 64 + j] = f2bf(acc[j]);
        }
    } else if (chunk < 12) {
#pragma unroll
        for (int j = 0; j < 64; ++j) VA[(size_t)m * 128 + (chunk - 10) * 64 + j] = f2bf(acc[j]);
    } else if (chunk < 48) {
        const int which = (chunk - 12) / 12, hb = (chunk - 12) % 12, g = hb / 4;
        if (which < 2) {
#pragma unroll
            for (int d = 0; d < 8; ++d) {
                const float inv = pr_inv(d);
                float s, c;
                sincos_acc((float)t * inv, s, c);
                const float x1 = acc[d], x2 = acc[d + 8]; acc[d] = x1 * c - x2 * s; acc[d + 8] = x2 * c + x1 * s;
            }
        }
        bf16_t* dst = (which == 0 ? QB : which == 1 ? KB : VB) + ((size_t)(b * BH + hb) * SEQ + sidx_of(t, g)) * 64;
        const float sc = which == 0 ? C2 : 1.f;
#pragma unroll
        for (int j = 0; j < 64; ++j) dst[j] = f2bf(acc[j] * sc);
    } else {
        const int c0 = (chunk - 48) * 64;
#pragma unroll
        for (int j = 0; j < 64; ++j) { const float z = acc[j] + b_gate[c0 + j]; G[(size_t)m * 2048 + c0 + j] = f2bf(1.f / (1.f + __expf(-z))); }
    }
}

__global__ void __launch_bounds__(256) k_attn_a(bf16_t* QO, const bf16_t* KA, const bf16_t* VA) {
    const int t = blockIdx.x * 256 + threadIdx.x, hq = blockIdx.y, b = blockIdx.z, kvh = hq / 4;
    const size_t m = (size_t)b * SEQ + t;
    float q[64], o[64];
#pragma unroll
    for (int j = 0; j < 64; ++j) { q[j] = bf2f(QO[m * 512 + hq * 64 + j]); o[j] = 0.f; }
    float mx = -1e30f, l = 0.f;
    for (int s = 0; s < SEQ; ++s) {
        const bf16_t* kr = KA + ((size_t)b * SEQ + s) * 128 + kvh * 64;
        const bf16_t* vr = VA + ((size_t)b * SEQ + s) * 128 + kvh * 64;
        float sc = 0.f;
#pragma unroll
        for (int j = 0; j < 64; ++j) sc = __builtin_fmaf(q[j], bf2f(kr[j]), sc);
        const float mn = fmaxf(mx, sc), al = exp2f(mx - mn), p = exp2f(sc - mn);
        l = l * al + p; mx = mn;
#pragma unroll
        for (int j = 0; j < 64; ++j) o[j] = __builtin_fmaf(p, bf2f(vr[j]), o[j] * al);
    }
    const float rl = 1.f / l;
#pragma unroll
    for (int j = 0; j < 64; ++j) QO[m * 512 + hq * 64 + j] = f2bf(o[j] * rl);
}

__global__ void __launch_bounds__(256) k_attn_b(bf16_t* QO, const bf16_t* KB, const bf16_t* VB, float* LSE) {
    const int sidx = blockIdx.x * 256 + threadIdx.x, hb = blockIdx.y, b = blockIdx.z, g = hb / 4;
    const int L = SEQ >> (2 * g), r = sidx / L, j0 = sidx % L;
    const size_t base = (size_t)(b * BH + hb) * SEQ;
    float q[64], o[64];
#pragma unroll
    for (int j = 0; j < 64; ++j) { q[j] = bf2f(QO[(base + sidx) * 64 + j]); o[j] = 0.f; }
    float mx = -1e30f, l = 0.f;
    const int lo = j0 - 64 < 0 ? 0 : j0 - 64, hi = j0 + 64 > L - 1 ? L - 1 : j0 + 64;
    for (int jj = lo; jj <= hi; ++jj) {
        const bf16_t* kr = KB + (base + r * L + jj) * 64;
        const bf16_t* vr = VB + (base + r * L + jj) * 64;
        float sc = 0.f;
#pragma unroll
        for (int j = 0; j < 64; ++j) sc = __builtin_fmaf(q[j], bf2f(kr[j]), sc);
        const float mn = fmaxf(mx, sc), al = exp2f(mx - mn), p = exp2f(sc - mn);
        l = l * al + p; mx = mn;
#pragma unroll
        for (int j = 0; j < 64; ++j) o[j] = __builtin_fmaf(p, bf2f(vr[j]), o[j] * al);
    }
    const float rl = 1.f / l;
#pragma unroll
    for (int j = 0; j < 64; ++j) QO[(base + sidx) * 64 + j] = f2bf(o[j] * rl);
    LSE[base + sidx] = (mx + log2f(l)) * LN2;
}

__global__ void __launch_bounds__(256) k_comb(const bf16_t* OBG, const float* LSE, bf16_t* COMB) {
    const int idx = blockIdx.x * 256 + threadIdx.x, m = idx >> 2, hs = idx & 3, b = m / SEQ, t = m % SEQ;
    float ls[3]; size_t off[3];
#pragma unroll
    for (int g = 0; g < 3; ++g) { off[g] = (size_t)(b * BH + g * 4 + hs) * SEQ + sidx_of(t, g); ls[g] = LSE[off[g]]; }
    const float mx = fmaxf(ls[0], fmaxf(ls[1], ls[2]));
    float w[3]; float sum = 0.f;
#pragma unroll
    for (int g = 0; g < 3; ++g) { w[g] = __expf(ls[g] - mx); sum += w[g]; }
#pragma unroll
    for (int d = 0; d < 64; ++d) {
        float v = 0.f;
#pragma unroll
        for (int g = 0; g < 3; ++g) v += (w[g] / sum) * bf2f(OBG[off[g] * 64 + d]);
        COMB[(size_t)m * 256 + hs * 64 + d] = f2bf(v);
    }
}

__global__ void __launch_bounds__(256) k_proj(const bf16_t* OA, const bf16_t* COMB, const bf16_t* G, const float* wpa, const float* wpb, bf16_t* MIXIN) {
    const int m = blockIdx.x * 256 + threadIdx.x, c0 = blockIdx.y * 64;
    float acc[64], acc2[64];
#pragma unroll
    for (int j = 0; j < 64; ++j) { acc[j] = 0.f; acc2[j] = 0.f; }
    dot64(OA + (size_t)m * 512, 512, wpa, DM, c0, acc);
    dot64(COMB + (size_t)m * 256, 256, wpb, DM, c0, acc2);
#pragma unroll
    for (int j = 0; j < 64; ++j) {
        const float ga = bf2f(G[(size_t)m * 2048 + c0 + j]), gb = bf2f(G[(size_t)m * 2048 + 1024 + c0 + j]);
        MIXIN[(size_t)m * DM + c0 + j] = f2bf(ga * acc[j] + gb * acc2[j]);
    }
}

__global__ void __launch_bounds__(256) k_wo(const bf16_t* MIXIN, const float* wo, const float* x, const float* mod, float* X1) {
    const int m = blockIdx.x * 256 + threadIdx.x, c0 = blockIdx.y * 64, b = m / SEQ;
    float acc[64];
#pragma unroll
    for (int j = 0; j < 64; ++j) acc[j] = 0.f;
    dot64(MIXIN + (size_t)m * DM, DM, wo, DM, c0, acc);
#pragma unroll
    for (int j = 0; j < 64; ++j) X1[(size_t)m * DM + c0 + j] = x[(size_t)m * DM + c0 + j] + mod[b * 6144 + 2048 + c0 + j] * acc[j];
}

__global__ void __launch_bounds__(256) k_ffn_in(const bf16_t* U2, const float* win, bf16_t* ACT) {
    const int m = blockIdx.x * 256 + threadIdx.x, c0 = blockIdx.y * 64;
    float acc[64], acc2[64];
#pragma unroll
    for (int j = 0; j < 64; ++j) { acc[j] = 0.f; acc2[j] = 0.f; }
    dot64(U2 + (size_t)m * DM, DM, win, 2 * DFF, c0, acc);
    dot64(U2 + (size_t)m * DM, DM, win, 2 * DFF, DFF + c0, acc2);
#pragma unroll
    for (int j = 0; j < 64; ++j) { const float hg = acc[j]; ACT[(size_t)m * DFF + c0 + j] = f2bf(hg / (1.f + __expf(-hg)) * acc2[j]); }
}

__global__ void __launch_bounds__(256) k_ffn_out(const bf16_t* ACT, const float* wout, const float* mod, float* X) {
    const int m = blockIdx.x * 256 + threadIdx.x, c0 = blockIdx.y * 64, b = m / SEQ;
    float acc[64];
#pragma unroll
    for (int j = 0; j < 64; ++j) acc[j] = 0.f;
    dot64(ACT + (size_t)m * DFF, DFF, wout, DM, c0, acc);
#pragma unroll
    for (int j = 0; j < 64; ++j) X[(size_t)m * DM + c0 + j] += mod[b * 6144 + 5120 + c0 + j] * acc[j];
}

extern "C" void kernel_launch(void* const* d_in, const int* in_sizes, int n_in, void* d_out, int out_size, void* d_ws, size_t ws_size, hipStream_t stream) {
    const float* x = (const float*)d_in[0]; const float* c = (const float*)d_in[1]; const float* w_ada = (const float*)d_in[2]; const float* b_ada = (const float*)d_in[3];
    const float* norm1_g = (const float*)d_in[4]; const float* w_qkv = (const float*)d_in[5]; const float* qn = (const float*)d_in[6]; const float* kn = (const float*)d_in[7];
    const float* wpa = (const float*)d_in[8]; const float* wpb = (const float*)d_in[9]; const float* w_gate = (const float*)d_in[10]; const float* b_gate = (const float*)d_in[11];
    const float* wo = (const float*)d_in[12]; const float* norm2_g = (const float*)d_in[13]; const float* win = (const float*)d_in[14]; const float* wout = (const float*)d_in[15];
    const float* fin_g = (const float*)d_in[16];
    if (ws_size < WS_END) { fprintf(stderr, "workspace too small: %zu\n", ws_size); return; }
    unsigned char* ws = (unsigned char*)d_ws; float* out = (float*)d_out;
    float* MOD = (float*)(ws + WS_MOD); float* LSE = (float*)(ws + WS_LSE);
    bf16_t* COMB = (bf16_t*)(ws + WS_COMB); bf16_t* U = (bf16_t*)(ws + WS_U);
    bf16_t* QA = (bf16_t*)(ws + WS_QA); bf16_t* KA = (bf16_t*)(ws + WS_KA); bf16_t* VA = (bf16_t*)(ws + WS_VA);
    bf16_t* QB = (bf16_t*)(ws + WS_QB); bf16_t* KB = (bf16_t*)(ws + WS_KB); bf16_t* VB = (bf16_t*)(ws + WS_VB);
    bf16_t* G = (bf16_t*)(ws + WS_G); bf16_t* MIXIN = (bf16_t*)(ws + WS_MIXIN); bf16_t* ACT = (bf16_t*)(ws + WS_ACT);

    k_mod<<<6144 / 256, 256, 0, stream>>>(c, w_ada, b_ada, MOD);
    k_rmsmod<<<M / 4, 256, 0, stream>>>(x, norm1_g, MOD, 0, 1024, U);
    k_qkv<<<dim3(M / 256, 80), 256, 0, stream>>>(U, w_qkv, w_gate, b_gate, qn, kn, QA, KA, VA, QB, KB, VB, G);
    k_attn_a<<<dim3(SEQ / 256, AQH, BATCH), 256, 0, stream>>>(QA, KA, VA);
    k_attn_b<<<dim3(SEQ / 256, BH, BATCH), 256, 0, stream>>>(QB, KB, VB, LSE);
    k_comb<<<M * 4 / 256, 256, 0, stream>>>(QB, LSE, COMB);
    k_proj<<<dim3(M / 256, 16), 256, 0, stream>>>(QA, COMB, G, wpa, wpb, MIXIN);
    k_wo<<<dim3(M / 256, 16), 256, 0, stream>>>(MIXIN, wo, x, MOD, out);
    k_rmsmod<<<M / 4, 256, 0, stream>>>(out, norm2_g, MOD, 3072, 4096, U);
    k_ffn_in<<<dim3(M / 256, 44), 256, 0, stream>>>(U, win, ACT);
    k_ffn_out<<<dim3(M / 256, 16), 256, 0, stream>>>(ACT, wout, MOD, out);
    k_rmsfinal<<<M / 4, 256, 0, stream>>>(out, fin_g);
}
```
